# Optimizing an MI355X kernel written in HIP

```python
import jax, jax.numpy as jnp
from jax import lax
import numpy as np

D_MODEL = 1024
BATCH = 4
SEQ = 8192
DEPTH = 1

HEAD_DIM = 64
ATTN_HEADS_PER_GROUP = 8
DILATED_GROUPS = ((128, 1), (512, 4), (2048, 16))
N_DIL = len(DILATED_GROUPS)
ATTN_WIDTH = ATTN_HEADS_PER_GROUP * HEAD_DIM
ROPE_DIM = HEAD_DIM // 4
ROPE_THETA = 500000.0
BLK = 128
SGU_CHUNK = 128
SGU_GROUPS = 8
SGU_WIDTH = D_MODEL // 2
SGU_GROUP_DIM = SGU_WIDTH // SGU_GROUPS
D_FF = -(-8 * D_MODEL // (3 * 256)) * 256
QKV_COLS = 3 * N_DIL * ATTN_WIDTH
IN_COLS = QKV_COLS + 2 * SGU_WIDTH + 2 * D_MODEL
EPS = 1e-6

kernel_name = "hybrid_dilated_attn_gmlp_gated_block"


def rmsnorm(x, g):
    xf = x.astype(jnp.float32)
    y = xf * lax.rsqrt(jnp.mean(xf * xf, axis=-1, keepdims=True) + EPS)
    return (y * g.astype(jnp.float32)).astype(x.dtype)


def layernorm(x, g, b):
    xf = x.astype(jnp.float32)
    mu = jnp.mean(xf, axis=-1, keepdims=True)
    xc = xf - mu
    y = xc * lax.rsqrt(jnp.mean(xc * xc, axis=-1, keepdims=True) + EPS)
    return (y * g.astype(jnp.float32) + b.astype(jnp.float32)).astype(x.dtype)


def partial_rope(t, positions):
    half = ROPE_DIM // 2
    inv_freq = ROPE_THETA ** (-jnp.arange(0, ROPE_DIM, 2, dtype=jnp.float32) / ROPE_DIM)
    ang = positions.astype(jnp.float32)[..., None] * inv_freq
    cos = jnp.cos(ang)[:, :, None, :]
    sin = jnp.sin(ang)[:, :, None, :]
    tf = t.astype(jnp.float32)
    x1, x2 = tf[..., :half], tf[..., half:ROPE_DIM]
    rot = jnp.concatenate([x1 * cos - x2 * sin, x2 * cos + x1 * sin, tf[..., ROPE_DIM:]], axis=-1)
    return rot.astype(t.dtype)


def dilated_attention(q, k, v, window, dilation):
    B, S, H, Dh = q.shape
    span = window // dilation
    L = -(-S // dilation)
    L_pad = -(-L // BLK) * BLK
    S_pad = L_pad * dilation
    nb = L_pad // BLK
    pad = ((0, 0), (0, S_pad - S), (0, 0), (0, 0))

    def strided(t):
        t = jnp.pad(t, pad).reshape(B, L_pad, dilation, H, Dh).transpose(0, 2, 1, 3, 4)
        return t.reshape(B, dilation, nb, BLK, H, Dh)

    def with_prev(t):
        prev = jnp.pad(t, ((0, 0), (0, 0), (1, 0), (0, 0), (0, 0), (0, 0)))[:, :, :-1]
        return jnp.concatenate([prev, t], axis=3)

    qs = strided(q * (Dh ** -0.5))
    kb = with_prev(strided(k))
    vb = with_prev(strided(v))
    s = jnp.einsum('brnqhd,brnkhd->brnhqk', qs, kb, preferred_element_type=jnp.float32)

    i = jnp.arange(BLK)[:, None]
    j = jnp.arange(2 * BLK)[None, :]
    diff = BLK + i - j
    band = (diff >= 0) & (diff <= span)
    key_exists = (jnp.arange(nb)[:, None, None] > 0) | (j >= BLK)[None]
    mask = band[None] & key_exists
    s = jnp.where(mask[None, None, :, None], s, -jnp.inf)

    m = jnp.max(s, axis=-1, keepdims=True)
    p = jnp.exp(s - m)
    den = jnp.sum(p, axis=-1)
    lse = m[..., 0] + jnp.log(den)
    o = jnp.einsum('brnhqk,brnkhd->brnqhd', p, vb.astype(jnp.float32))
    o = o / jnp.swapaxes(den, -1, -2)[..., None]

    o = o.reshape(B, dilation, L_pad, H, Dh).transpose(0, 2, 1, 3, 4).reshape(B, S_pad, H, Dh)[:, :S]
    lse = jnp.swapaxes(lse, -1, -2).reshape(B, dilation, L_pad, H).transpose(0, 2, 1, 3)
    lse = lse.reshape(B, S_pad, H)[:, :S]
    return o.astype(q.dtype), lse


def spatial_gating(uv, ln_g, ln_b, w_s, b_s):
    B, S, _ = uv.shape
    z = jax.nn.gelu(uv, approximate=False)
    u, v = z[..., :SGU_WIDTH], z[..., SGU_WIDTH:]
    v = layernorm(v, ln_g, ln_b)
    vc = v.reshape(B, S // SGU_CHUNK, SGU_CHUNK, SGU_GROUPS, SGU_GROUP_DIM)
    causal = jnp.tril(jnp.ones((SGU_CHUNK, SGU_CHUNK), dtype=bool))
    w_causal = jnp.where(causal[None], w_s, jnp.zeros_like(w_s))
    mixed = jnp.einsum('gts,bnsgc->bntgc', w_causal, vc)
    mixed = mixed + jnp.transpose(b_s)[None, None, :, :, None]
    return u * mixed.reshape(B, S, SGU_WIDTH)


def setup_inputs(seed: int = 0) -> dict:
    key = jax.random.key(seed)
    ks = jax.random.split(key, 18)
    f32 = jnp.float32
    x = jax.random.normal(ks[0], (BATCH, SEQ, D_MODEL), f32)
    offset = jax.random.randint(ks[1], (BATCH, 1), 0, 4096, dtype=jnp.int32)
    positions = offset + jnp.arange(SEQ, dtype=jnp.int32)[None, :]
    nrm = lambda k, shape, fan_in: jax.random.normal(k, shape, f32) * (fan_in ** -0.5)
    return {
        "x": x,
        "positions": positions,
        "norm1_g": 1.0 + 0.02 * jax.random.normal(ks[2], (DEPTH, D_MODEL), f32),
        "w_in": nrm(ks[3], (DEPTH, D_MODEL, IN_COLS), D_MODEL),
        "sgu_ln_g": 1.0 + 0.02 * jax.random.normal(ks[4], (DEPTH, SGU_WIDTH), f32),
        "sgu_ln_b": 0.02 * jax.random.normal(ks[5], (DEPTH, SGU_WIDTH), f32),
        "w_spatial": nrm(ks[6], (DEPTH, SGU_GROUPS, SGU_CHUNK, SGU_CHUNK), SGU_CHUNK),
        "b_spatial": 1.0 + 0.1 * jax.random.normal(ks[7], (DEPTH, SGU_GROUPS, SGU_CHUNK), f32),
        "w_proj_attn": nrm(ks[8], (DEPTH, ATTN_WIDTH, D_MODEL), ATTN_WIDTH),
        "w_proj_sgu": nrm(ks[9], (DEPTH, SGU_WIDTH, D_MODEL), SGU_WIDTH),
        "w_out": nrm(ks[10], (DEPTH, D_MODEL, D_MODEL), D_MODEL),
        "norm2_g": 1.0 + 0.02 * jax.random.normal(ks[11], (DEPTH, D_MODEL), f32),
        "w_ffn_gate": nrm(ks[12], (DEPTH, D_MODEL, D_FF), D_MODEL),
        "w_ffn_up": nrm(ks[13], (DEPTH, D_MODEL, D_FF), D_MODEL),
        "w_ffn_down": nrm(ks[14], (DEPTH, D_FF, D_MODEL), D_FF),
        "final_g": 1.0 + 0.02 * jax.random.normal(ks[15], (D_MODEL,), f32),
    }


def reference(x, positions, norm1_g, w_in, sgu_ln_g, sgu_ln_b, w_spatial, b_spatial,
              w_proj_attn, w_proj_sgu, w_out, norm2_g, w_ffn_gate, w_ffn_up, w_ffn_down,
              final_g):
    B, S, _ = x.shape
    for l in range(DEPTH):
        h = rmsnorm(x, norm1_g[l])
        proj = h @ w_in[l]
        qkv = proj[..., :QKV_COLS].reshape(B, S, 3, N_DIL, ATTN_HEADS_PER_GROUP, HEAD_DIM)
        uv = proj[..., QKV_COLS:QKV_COLS + 2 * SGU_WIDTH]
        gate_a = jax.nn.sigmoid(proj[..., QKV_COLS + 2 * SGU_WIDTH:QKV_COLS + 2 * SGU_WIDTH + D_MODEL])
        gate_b = jax.nn.sigmoid(proj[..., QKV_COLS + 2 * SGU_WIDTH + D_MODEL:])

        outs, lses = [], []
        for g, (window, dilation) in enumerate(DILATED_GROUPS):
            q = partial_rope(qkv[:, :, 0, g], positions)
            k = partial_rope(qkv[:, :, 1, g], positions)
            o, lse = dilated_attention(q, k, qkv[:, :, 2, g], window, dilation)
            outs.append(o)
            lses.append(lse)
        alpha = jax.nn.softmax(jnp.stack(lses, axis=0), axis=0)
        attn = jnp.sum(alpha[..., None].astype(x.dtype) * jnp.stack(outs, axis=0), axis=0)
        attn = attn.reshape(B, S, ATTN_WIDTH)

        sgu = spatial_gating(uv, sgu_ln_g[l], sgu_ln_b[l], w_spatial[l], b_spatial[l])

        merged = gate_a * (attn @ w_proj_attn[l]) + gate_b * (sgu @ w_proj_sgu[l])
        x = x + merged @ w_out[l]

        h2 = rmsnorm(x, norm2_g[l])
        ff = jax.nn.silu(h2 @ w_ffn_gate[l]) * (h2 @ w_ffn_up[l])
        x = x + ff @ w_ffn_down[l]
    return rmsnorm(x, final_g)
```

```cpp
#include <hip/hip_runtime.h>
#include <cstdio>
#include <cstdint>
#include <cmath>

constexpr int NB = 4, SEQ = 8192, T = NB * SEQ, DM = 1024, NHEAD = 8, HD = 64, NGRP = 3, AW = 512;
constexpr int QKVC = 3 * NGRP * AW, SGUW = 512, INC = QKVC + 2 * SGUW + 2 * DM, DFF = 2816;
constexpr float EPS = 1e-6f;
constexpr float QSCALE = 0.125f * 1.4426950408889634f;

typedef unsigned short bf16;
typedef float f32x4 __attribute__((ext_vector_type(4)));
typedef unsigned u32x4 __attribute__((ext_vector_type(4)));
typedef unsigned u32x2 __attribute__((ext_vector_type(2)));

__device__ __forceinline__ unsigned f2bf(float f) { unsigned u = __builtin_bit_cast(unsigned, f); return (u + 0x7fffu + ((u >> 16) & 1u)) >> 16; }
__device__ __forceinline__ float bf2f(unsigned h) { return __builtin_bit_cast(float, h << 16); }
__device__ __forceinline__ unsigned pk2(float lo, float hi) { return f2bf(lo) | (f2bf(hi) << 16); }

constexpr size_t MiB = 1u << 20;
constexpr size_t WS_CTL = 0;
constexpr size_t WS_COS = 1 * MiB, WS_SIN = 2 * MiB;
constexpr size_t WS_WSP = 3 * MiB;
constexpr size_t WS_STATS = 3 * MiB + 512 * 1024;
constexpr size_t WS_SSQ1 = 4 * MiB, WS_SSQ2 = 6 * MiB;
constexpr size_t WS_LSE = 8 * MiB;
constexpr size_t WS_W1T = 12 * MiB, WS_WCT = 27 * MiB, WS_WOT = 29 * MiB, WS_W5T = 31 * MiB, WS_W6T = 42 * MiB;
constexpr size_t WS_A = 48 * MiB;
constexpr size_t WS_C = 112 * MiB;
constexpr size_t WS_Q = 176 * MiB, WS_K = 272 * MiB, WS_V = 368 * MiB;
constexpr size_t WS_FF = 176 * MiB;
constexpr size_t WS_H2 = 352 * MiB;
constexpr size_t WS_TMP5 = 416 * MiB;
constexpr size_t WS_TMP3 = 176 * MiB;
constexpr size_t WS_TMP1 = 464 * MiB;
constexpr size_t WS_END = 512 * MiB;

__host__ __device__ __forceinline__ int dil_of(int g) { return g == 0 ? 1 : (g == 1 ? 4 : 16); }
__host__ __device__ __forceinline__ int ppos(int s, int g) { const int d = dil_of(g), L = SEQ / d; return (s % d) * L + s / d; }
__host__ __device__ __forceinline__ int slot2dim(int sl) { if (sl >= 16) return sl; const int c = sl >> 3, j = sl & 7; return j < 4 ? 4 * c + j : 8 + 4 * c + (j - 4); }
__host__ __device__ __forceinline__ size_t q_off(int b, int g, int h, int p, int sl) { return ((((size_t)b * NGRP + g) * NHEAD + h) * SEQ + p) * HD + sl; }
__host__ __device__ __forceinline__ size_t k_off(int b, int g, int h, int p, int sl) { return (((((size_t)b * NGRP + g) * NHEAD + h) * 8 + (sl >> 3)) * SEQ + p) * 8 + (sl & 7); }
__host__ __device__ __forceinline__ size_t v_off(int b, int g, int h, int p, int d) { return (((((size_t)b * NGRP + g) * NHEAD + h) * 2 + (d >> 5)) * SEQ + p) * 32 + (d & 31); }
__host__ __device__ __forceinline__ size_t lse_off(int b, int g, int h, int p) { return (((size_t)b * NGRP + g) * NHEAD + h) * SEQ + p; }

__device__ __forceinline__ float wave_sum(float v) {
#pragma unroll
    for (int o = 1; o < 64; o <<= 1) v += __shfl_xor(v, o);
    return v;
}
__device__ __forceinline__ float gelu_exact(float v) { return 0.5f * v * (1.0f + erff(v * 0.70710678118654752f)); }
__device__ __forceinline__ float sigmoidf_(float v) { return 1.0f / (1.0f + __expf(-v)); }

__global__ void __launch_bounds__(256) nk_rms_h(const float* __restrict__ x, const float* __restrict__ g, bf16* __restrict__ h) {
    const int row = blockIdx.x * 4 + (threadIdx.x >> 6), lane = threadIdx.x & 63;
    const f32x4* xr = (const f32x4*)(x + (size_t)row * DM) + lane;
    f32x4 v[4]; float s = 0.f;
#pragma unroll
    for (int j = 0; j < 4; ++j) { v[j] = xr[64 * j]; s += v[j].x * v[j].x + v[j].y * v[j].y + v[j].z * v[j].z + v[j].w * v[j].w; }
    const float rs = rsqrtf(wave_sum(s) * (1.f / DM) + EPS);
    u32x2* o = (u32x2*)(h + (size_t)row * DM) + lane;
#pragma unroll
    for (int j = 0; j < 4; ++j) { const f32x4 gg = ((const f32x4*)g)[lane + 64 * j]; u32x2 w; w.x = pk2(v[j].x * rs * gg.x, v[j].y * rs * gg.y); w.y = pk2(v[j].z * rs * gg.z, v[j].w * rs * gg.w); o[64 * j] = w; }
}
__global__ void nk_rope_table(const int* __restrict__ pos, float* __restrict__ ct, float* __restrict__ st) {
    const int idx = blockIdx.x * blockDim.x + threadIdx.x; if (idx >= T * 8) return;
    const int t = idx >> 3, i = idx & 7;
    const float inv = (float)pow(500000.0, -(double)(2 * i) / 16.0);
    const float ang = (float)pos[t] * inv;
    const double a = (double)ang; const double n = rint(a * 0.15915494309189535); const float r = (float)(a - n * 6.283185307179586);
    ct[idx] = cosf(r); st[idx] = sinf(r);
}

template <class Epi>
__global__ void __launch_bounds__(256) nk_gemm(const bf16* __restrict__ A, int lda, const float* __restrict__ Bm, int ldb, int K, Epi E) {
    __shared__ float As[16][68];
    __shared__ float Bs[16][68];
    const int tid = threadIdx.x, tx = tid & 15, ty = tid >> 4;
    const int row0 = blockIdx.y * 64, col0 = blockIdx.x * 64;
    float acc[4][4];
#pragma unroll
    for (int i = 0; i < 4; ++i)
#pragma unroll
        for (int j = 0; j < 4; ++j) acc[i][j] = 0.f;
    const int ar = tid >> 2, ak = (tid & 3) * 4;
    const int bk = tid >> 4, bc = (tid & 15) * 4;
    for (int k0 = 0; k0 < K; k0 += 16) {
        const u32x2 av = *(const u32x2*)(A + (size_t)(row0 + ar) * lda + k0 + ak);
        const f32x4 bv = *(const f32x4*)(Bm + (size_t)(k0 + bk) * ldb + col0 + bc);
        __syncthreads();
        As[ak + 0][ar] = bf2f(av.x & 0xffffu); As[ak + 1][ar] = bf2f(av.x >> 16); As[ak + 2][ar] = bf2f(av.y & 0xffffu); As[ak + 3][ar] = bf2f(av.y >> 16);
        *(f32x4*)&Bs[bk][bc] = bv;
        __syncthreads();
#pragma unroll
        for (int k = 0; k < 16; ++k) {
            const f32x4 a = *(const f32x4*)&As[k][ty * 4]; const f32x4 b = *(const f32x4*)&Bs[k][tx * 4];
#pragma unroll
            for (int i = 0; i < 4; ++i)
#pragma unroll
                for (int j = 0; j < 4; ++j) acc[i][j] += a[i] * b[j];
        }
    }
#pragma unroll
    for (int i = 0; i < 4; ++i)
#pragma unroll
        for (int j = 0; j < 4; ++j) E(row0 + ty * 4 + i, col0 + tx * 4 + j, acc[i][j]);
}
struct EpiRaw { float* C; int ldc; int pad; __device__ __forceinline__ void operator()(int r, int c, float v) const { C[(size_t)r * ldc + c] = v; } };
struct EpiV { bf16* V; int g; int pad; __device__ __forceinline__ void operator()(int r, int c, float v) const {
    const int b = r / SEQ, s = r % SEQ; V[v_off(b, g, c >> 6, ppos(s, g), c & 63)] = (bf16)f2bf(v); } };
struct EpiGelu { bf16* O; int ldo; int pad; __device__ __forceinline__ void operator()(int r, int c, float v) const { O[(size_t)r * ldo + c] = (bf16)f2bf(gelu_exact(v)); } };
struct EpiSig { bf16* O; int ldo; int pad; __device__ __forceinline__ void operator()(int r, int c, float v) const { O[(size_t)r * ldo + c] = (bf16)f2bf(sigmoidf_(v)); } };
__global__ void nk_rope_qk(const float* __restrict__ raw, const float* __restrict__ ct, const float* __restrict__ st, bf16* __restrict__ dst, int which, int g, int hb) {
    const size_t idx = (size_t)blockIdx.x * blockDim.x + threadIdx.x; if (idx >= (size_t)T * 256) return;
    const int t = (int)(idx >> 8), c = (int)(idx & 255), hl = c >> 6, sl = c & 63, d = slot2dim(sl);
    const float* rr = raw + (size_t)t * 256 + hl * 64;
    float val;
    if (d < 16) { const int i = d & 7; const float x1 = rr[i], x2 = rr[i + 8], co = ct[t * 8 + i], si = st[t * 8 + i]; val = d < 8 ? x1 * co - x2 * si : x2 * co + x1 * si; }
    else val = rr[d];
    const int b = t / SEQ, s = t % SEQ, p = ppos(s, g), h = hb + hl;
    if (which == 0) dst[q_off(b, g, h, p, sl)] = (bf16)f2bf(val * QSCALE);
    else dst[k_off(b, g, h, p, sl)] = (bf16)f2bf(val);
}
__global__ void __launch_bounds__(256) nk_attn(bf16* __restrict__ QO, const bf16* __restrict__ Kb, const bf16* __restrict__ Vb, float* __restrict__ lse) {
    const size_t idx = (size_t)blockIdx.x * 256 + threadIdx.x;
    const int p = (int)(idx % SEQ); const int bgh = (int)(idx / SEQ); const int h = bgh % NHEAD, g = (bgh / NHEAD) % NGRP, b = bgh / (NHEAD * NGRP);
    const int L = SEQ / dil_of(g), seg0 = (p / L) * L;
    float q[64], o[64];
    { const u32x4* qp = (const u32x4*)(QO + q_off(b, g, h, p, 0));
#pragma unroll
      for (int c = 0; c < 8; ++c) { const u32x4 w = qp[c];
#pragma unroll
          for (int j = 0; j < 4; ++j) { q[c * 8 + 2 * j] = bf2f(w[j] & 0xffffu); q[c * 8 + 2 * j + 1] = bf2f(w[j] >> 16); } } }
#pragma unroll
    for (int d = 0; d < 64; ++d) o[d] = 0.f;
    float m = -INFINITY, l = 0.f;
    int k0 = p - 128; if (k0 < seg0) k0 = seg0;
    for (int kp = k0; kp <= p; ++kp) {
        float s = 0.f;
#pragma unroll
        for (int c = 0; c < 8; ++c) { const u32x4 w = *(const u32x4*)(Kb + k_off(b, g, h, kp, c * 8));
#pragma unroll
            for (int j = 0; j < 4; ++j) { s += q[c * 8 + 2 * j] * bf2f(w[j] & 0xffffu); s += q[c * 8 + 2 * j + 1] * bf2f(w[j] >> 16); } }
        const float mn = fmaxf(m, s), f = exp2f(m - mn), pe = exp2f(s - mn);
        l = l * f + pe; m = mn;
#pragma unroll
        for (int c = 0; c < 8; ++c) { const u32x4 w = *(const u32x4*)(Vb + v_off(b, g, h, kp, c * 8));
#pragma unroll
            for (int j = 0; j < 4; ++j) { o[c * 8 + 2 * j] = o[c * 8 + 2 * j] * f + pe * bf2f(w[j] & 0xffffu); o[c * 8 + 2 * j + 1] = o[c * 8 + 2 * j + 1] * f + pe * bf2f(w[j] >> 16); } }
    }
    const float il = 1.f / l;
    u32x4* op = (u32x4*)(QO + q_off(b, g, h, p, 0));
#pragma unroll
    for (int c = 0; c < 8; ++c) { u32x4 w;
#pragma unroll
        for (int j = 0; j < 4; ++j) w[j] = pk2(o[c * 8 + 2 * j] * il, o[c * 8 + 2 * j + 1] * il);
        op[c] = w; }
    lse[lse_off(b, g, h, p)] = m + log2f(l);
}
__global__ void nk_combine(const bf16* __restrict__ O, const float* __restrict__ lse, bf16* __restrict__ AS) {
    const size_t idx = (size_t)blockIdx.x * blockDim.x + threadIdx.x; if (idx >= (size_t)T * AW) return;
    const int t = (int)(idx / AW), c = (int)(idx % AW), h = c >> 6, d = c & 63, b = t / SEQ, s = t % SEQ;
    float ls[3], ov[3];
#pragma unroll
    for (int g = 0; g < 3; ++g) { const int p = ppos(s, g); ls[g] = lse[lse_off(b, g, h, p)]; ov[g] = bf2f(O[q_off(b, g, h, p, d)]); }
    const float mx = fmaxf(ls[0], fmaxf(ls[1], ls[2]));
    const float e0 = exp2f(ls[0] - mx), e1 = exp2f(ls[1] - mx), e2 = exp2f(ls[2] - mx), inv = 1.f / (e0 + e1 + e2);
    AS[(size_t)t * DM + c] = (bf16)f2bf((e0 * ov[0] + e1 * ov[1] + e2 * ov[2]) * inv);
}
__global__ void __launch_bounds__(256) nk_lnstats(const bf16* __restrict__ UV, float* __restrict__ stats) {
    const int row = blockIdx.x * 4 + (threadIdx.x >> 6), lane = threadIdx.x & 63;
    const u32x4 w = *((const u32x4*)(UV + (size_t)row * DM + SGUW) + lane);
    float v[8]; float s = 0.f;
#pragma unroll
    for (int j = 0; j < 4; ++j) { v[2 * j] = bf2f(w[j] & 0xffffu); v[2 * j + 1] = bf2f(w[j] >> 16); s += v[2 * j] + v[2 * j + 1]; }
    const float mean = wave_sum(s) * (1.f / SGUW); float q = 0.f;
#pragma unroll
    for (int j = 0; j < 8; ++j) { const float d = v[j] - mean; q += d * d; }
    const float rstd = rsqrtf(wave_sum(q) * (1.f / SGUW) + EPS);
    if (lane == 0) { stats[2 * row] = mean; stats[2 * row + 1] = rstd; }
}
__global__ void nk_sgu(const bf16* __restrict__ UV, const float* __restrict__ stats, const float* __restrict__ lng, const float* __restrict__ lnb,
                       const float* __restrict__ wsp, const float* __restrict__ bsp, bf16* __restrict__ AS) {
    const size_t idx = (size_t)blockIdx.x * blockDim.x + threadIdx.x; if (idx >= (size_t)T * SGUW) return;
    const int t = (int)(idx / SGUW), c = (int)(idx % SGUW), g = c >> 6, ti = t & 127, t0 = t - ti;
    const float gg = lng[c], bb = lnb[c];
    float acc = 0.f;
    for (int s = 0; s <= ti; ++s) { const float vn = (bf2f(UV[(size_t)(t0 + s) * DM + SGUW + c]) - stats[2 * (t0 + s)]) * stats[2 * (t0 + s) + 1] * gg + bb;
        acc += wsp[((size_t)g * 128 + ti) * 128 + s] * vn; }
    const float u = bf2f(UV[(size_t)t * DM + c]);
    AS[(size_t)t * DM + SGUW + c] = (bf16)f2bf(u * (acc + bsp[g * 128 + ti]));
}
struct EpiG3a { float* tmp; const bf16* gate; __device__ __forceinline__ void operator()(int r, int c, float v) const { tmp[(size_t)r * DM + c] = bf2f(gate[(size_t)r * 2048 + c]) * v; } };
struct EpiG3b { const float* tmp; const bf16* gate; bf16* merged; __device__ __forceinline__ void operator()(int r, int c, float v) const {
    merged[(size_t)r * DM + c] = (bf16)f2bf(tmp[(size_t)r * DM + c] + bf2f(gate[(size_t)r * 2048 + 1024 + c]) * v); } };
struct EpiG4 { const float* x; float* x1; bf16* x1b; __device__ __forceinline__ void operator()(int r, int c, float v) const {
    const float o = x[(size_t)r * DM + c] + v; x1[(size_t)r * DM + c] = o; x1b[(size_t)r * DM + c] = (bf16)f2bf(o); } };
__global__ void __launch_bounds__(256) nk_ssq(const float* __restrict__ x, float* __restrict__ part) {
    const int row = blockIdx.x * 4 + (threadIdx.x >> 6), lane = threadIdx.x & 63;
    const f32x4* xr = (const f32x4*)(x + (size_t)row * DM) + lane; float s = 0.f;
#pragma unroll
    for (int j = 0; j < 4; ++j) { const f32x4 v = xr[64 * j]; s += v.x * v.x + v.y * v.y + v.z * v.z + v.w * v.w; }
    s = wave_sum(s);
    if (lane < 16) part[(size_t)row * 16 + lane] = lane == 0 ? s : 0.f;
}
__device__ __forceinline__ float rs_from_part(const float* part, int row) {
    const f32x4* p = (const f32x4*)(part + (size_t)row * 16); const f32x4 a = p[0], b = p[1], c = p[2], d = p[3];
    const float s = ((a.x + a.y) + (a.z + a.w)) + ((b.x + b.y) + (b.z + b.w)) + ((c.x + c.y) + (c.z + c.w)) + ((d.x + d.y) + (d.z + d.w));
    return rsqrtf(s * (1.f / DM) + EPS);
}
__global__ void __launch_bounds__(256) nk_h2(const bf16* __restrict__ x1b, const float* __restrict__ part, const float* __restrict__ g2, bf16* __restrict__ h2) {
    const int row = blockIdx.x * 4 + (threadIdx.x >> 6), lane = threadIdx.x & 63;
    const float rs = rs_from_part(part, row);
#pragma unroll
    for (int j = 0; j < 2; ++j) { const int c0 = (lane + 64 * j) * 8; const u32x4 w = *(const u32x4*)(x1b + (size_t)row * DM + c0); u32x4 o;
#pragma unroll
        for (int e = 0; e < 4; ++e) o[e] = pk2(bf2f(w[e] & 0xffffu) * rs * g2[c0 + 2 * e], bf2f(w[e] >> 16) * rs * g2[c0 + 2 * e + 1]);
        *(u32x4*)(h2 + (size_t)row * DM + c0) = o; }
}
struct EpiG5a { float* tmp; __device__ __forceinline__ void operator()(int r, int c, float v) const { tmp[(size_t)r * 256 + c] = v / (1.f + __expf(-v)); } };
struct EpiG5b { const float* tmp; bf16* ff; int cb; int pad; __device__ __forceinline__ void operator()(int r, int c, float v) const { ff[(size_t)r * DFF + cb + c] = (bf16)f2bf(tmp[(size_t)r * 256 + c] * v); } };
struct EpiG6 { float* x; __device__ __forceinline__ void operator()(int r, int c, float v) const { x[(size_t)r * DM + c] += v; } };
__global__ void __launch_bounds__(256) nk_final(float* __restrict__ x, const float* __restrict__ part, const float* __restrict__ g) {
    const int row = blockIdx.x * 4 + (threadIdx.x >> 6), lane = threadIdx.x & 63;
    const float rs = rs_from_part(part, row);
    f32x4* xr = (f32x4*)(x + (size_t)row * DM) + lane;
#pragma unroll
    for (int j = 0; j < 4; ++j) { const f32x4 gg = ((const f32x4*)g)[lane + 64 * j]; f32x4 v = xr[64 * j]; v.x *= rs * gg.x; v.y *= rs * gg.y; v.z *= rs * gg.z; v.w *= rs * gg.w; xr[64 * j] = v; }
}

template <class Epi> static void run_gemm(hipStream_t st, const bf16* A, int lda, const float* Bm, int ldb, int M, int N, int K, Epi E) {
    hipLaunchKernelGGL(nk_gemm<Epi>, dim3(N / 64, M / 64), dim3(256), 0, st, A, lda, Bm, ldb, K, E);
}

struct Ptrs {
    const float *x; const int* pos; const float *n1g, *w_in, *lng, *lnb, *wsp, *bsp, *wpa, *wpb, *wout, *n2g, *wg, *wu, *wd, *fg;
    float* out; unsigned char* ws;
};

static void naive_p0(const Ptrs& P, hipStream_t st) {
    hipLaunchKernelGGL(nk_rms_h, dim3(T / 4), dim3(256), 0, st, P.x, P.n1g, (bf16*)(P.ws + WS_A));
    hipLaunchKernelGGL(nk_rope_table, dim3(T * 8 / 256), dim3(256), 0, st, P.pos, (float*)(P.ws + WS_COS), (float*)(P.ws + WS_SIN));
}
static void naive_g1(const Ptrs& P, hipStream_t st) {
    const bf16* h = (const bf16*)(P.ws + WS_A); float* tmp = (float*)(P.ws + WS_TMP1);
    for (int which = 0; which < 2; ++which) for (int g = 0; g < 3; ++g) for (int hb = 0; hb < 8; hb += 4) {
        run_gemm(st, h, DM, P.w_in + which * 1536 + g * 512 + hb * 64, INC, T, 256, DM, EpiRaw{tmp, 256});
        hipLaunchKernelGGL(nk_rope_qk, dim3(T), dim3(256), 0, st, tmp, (const float*)(P.ws + WS_COS), (const float*)(P.ws + WS_SIN), (bf16*)(P.ws + (which == 0 ? WS_Q : WS_K)), which, g, hb);
    }
    for (int g = 0; g < 3; ++g) run_gemm(st, h, DM, P.w_in + 3072 + g * 512, INC, T, 512, DM, EpiV{(bf16*)(P.ws + WS_V), g});
    run_gemm(st, h, DM, P.w_in + QKVC, INC, T, 1024, DM, EpiGelu{(bf16*)(P.ws + WS_C), DM});
    run_gemm(st, h, DM, P.w_in + QKVC + 1024, INC, T, 2048, DM, EpiSig{(bf16*)P.out, 2048});
}
static void naive_attn(const Ptrs& P, hipStream_t st) {
    hipLaunchKernelGGL(nk_attn, dim3(NB * NGRP * NHEAD * SEQ / 256), dim3(256), 0, st, (bf16*)(P.ws + WS_Q), (const bf16*)(P.ws + WS_K), (const bf16*)(P.ws + WS_V), (float*)(P.ws + WS_LSE));
}
static void naive_p3(const Ptrs& P, hipStream_t st) {
    hipLaunchKernelGGL(nk_combine, dim3(T * AW / 256), dim3(256), 0, st, (const bf16*)(P.ws + WS_Q), (const float*)(P.ws + WS_LSE), (bf16*)(P.ws + WS_A));
    hipLaunchKernelGGL(nk_lnstats, dim3(T / 4), dim3(256), 0, st, (const bf16*)(P.ws + WS_C), (float*)(P.ws + WS_STATS));
    hipLaunchKernelGGL(nk_sgu, dim3(T * SGUW / 256), dim3(256), 0, st, (const bf16*)(P.ws + WS_C), (const float*)(P.ws + WS_STATS), P.lng, P.lnb, P.wsp, P.bsp, (bf16*)(P.ws + WS_A));
}
static void naive_g3(const Ptrs& P, hipStream_t st) {
    const bf16* AS = (const bf16*)(P.ws + WS_A); float* tmp = (float*)(P.ws + WS_TMP3);
    run_gemm(st, AS, DM, P.wpa, DM, T, DM, AW, EpiG3a{tmp, (const bf16*)P.out});
    run_gemm(st, AS + AW, DM, P.wpb, DM, T, DM, SGUW, EpiG3b{tmp, (const bf16*)P.out, (bf16*)(P.ws + WS_C)});
}
static void naive_g4(const Ptrs& P, hipStream_t st) {
    run_gemm(st, (const bf16*)(P.ws + WS_C), DM, P.wout, DM, T, DM, DM, EpiG4{P.x, P.out, (bf16*)(P.ws + WS_A)});
    hipLaunchKernelGGL(nk_ssq, dim3(T / 4), dim3(256), 0, st, (const float*)P.out, (float*)(P.ws + WS_SSQ1));
}
static void naive_g5(const Ptrs& P, hipStream_t st) {
    bf16* h2 = (bf16*)(P.ws + WS_H2); float* tmp = (float*)(P.ws + WS_TMP5);
    hipLaunchKernelGGL(nk_h2, dim3(T / 4), dim3(256), 0, st, (const bf16*)(P.ws + WS_A), (const float*)(P.ws + WS_SSQ1), P.n2g, h2);
    for (int cb = 0; cb < DFF; cb += 256) {
        run_gemm(st, h2, DM, P.wg + cb, DFF, T, 256, DM, EpiG5a{tmp});
        run_gemm(st, h2, DM, P.wu + cb, DFF, T, 256, DM, EpiG5b{tmp, (bf16*)(P.ws + WS_FF), cb});
    }
}
static void naive_g6(const Ptrs& P, hipStream_t st) {
    run_gemm(st, (const bf16*)(P.ws + WS_FF), DFF, P.wd, DM, T, DM, DFF, EpiG6{P.out});
    hipLaunchKernelGGL(nk_ssq, dim3(T / 4), dim3(256), 0, st, (const float*)P.out, (float*)(P.ws + WS_SSQ2));
}
static void naive_final(const Ptrs& P, hipStream_t st) {
    hipLaunchKernelGGL(nk_final, dim3(T / 4), dim3(256), 0, st, P.out, (const float*)(P.ws + WS_SSQ2), P.fg);
}

extern "C" void kernel_launch(void* const* d_in, const int* in_sizes, int n_in, void* d_out, int out_size, void* d_ws, size_t ws_size, hipStream_t stream) {
    if (n_in != 16 || in_sizes[0] != T * DM || out_size != T * DM || ws_size < WS_END) {
        fprintf(stderr, "kernel_launch: unexpected shapes (n_in %d, in0 %d, out %d, ws %zu)\n", n_in, n_in > 0 ? in_sizes[0] : -1, out_size, ws_size); return; }
    Ptrs P{};
    P.x = (const float*)d_in[0]; P.pos = (const int*)d_in[1]; P.n1g = (const float*)d_in[2]; P.w_in = (const float*)d_in[3]; P.lng = (const float*)d_in[4]; P.lnb = (const float*)d_in[5];
    P.wsp = (const float*)d_in[6]; P.bsp = (const float*)d_in[7]; P.wpa = (const float*)d_in[8]; P.wpb = (const float*)d_in[9]; P.wout = (const float*)d_in[10]; P.n2g = (const float*)d_in[11];
    P.wg = (const float*)d_in[12]; P.wu = (const float*)d_in[13]; P.wd = (const float*)d_in[14]; P.fg = (const float*)d_in[15];
    P.out = (float*)d_out; P.ws = (unsigned char*)d_ws;
    naive_p0(P, stream); naive_g1(P, stream); naive_attn(P, stream); naive_p3(P, stream); naive_g3(P, stream); naive_g4(P, stream); naive_g5(P, stream); naive_g6(P, stream); naive_final(P, stream);
}
```
